# Optimizing an MI355X kernel written in HIP

```python
import jax, jax.numpy as jnp
from jax import lax
import numpy as np

D_MODEL = 1024
BATCH = 32
SEQ = 2048
DEPTH = 1

HEAD_DIM = 64
N_Q_HEADS = 8
N_KV_HEADS = 2
Q_PER_KV = N_Q_HEADS // N_KV_HEADS
ATTN_WIDTH = N_Q_HEADS * HEAD_DIM
KV_WIDTH = N_KV_HEADS * HEAD_DIM
WINDOW = 128
BLOCK = WINDOW
ROPE_THETA = 10000.0
POOL_WINDOWS = (2, 4, 8, 16)
N_POOL_GROUPS = len(POOL_WINDOWS)
POOL_WIDTH = D_MODEL - ATTN_WIDTH
POOL_GROUP_DIM = POOL_WIDTH // N_POOL_GROUPS
MIX_WIDTH = ATTN_WIDTH + POOL_WIDTH
IN_WIDTH = ATTN_WIDTH + 2 * KV_WIDTH + POOL_WIDTH
D_FF = 4 * D_MODEL
EPS = 1e-6

kernel_name = "hymba_swa_sink_multiscale_pool_block"


def _rmsnorm(x, g):
    xf = x.astype(jnp.float32)
    y = xf * lax.rsqrt(jnp.mean(xf * xf, axis=-1, keepdims=True) + EPS)
    return (y * g.astype(jnp.float32)).astype(x.dtype)


def _rope(x, pos):
    half = HEAD_DIM // 2
    inv_freq = ROPE_THETA ** (-jnp.arange(half, dtype=jnp.float32) / half)
    ang = pos.astype(jnp.float32)[:, None] * inv_freq[None, :]
    cos = jnp.cos(ang)[None, :, None, :]
    sin = jnp.sin(ang)[None, :, None, :]
    xf = x.astype(jnp.float32)
    x1, x2 = xf[..., :half], xf[..., half:]
    out = jnp.concatenate([x1 * cos - x2 * sin, x2 * cos + x1 * sin], axis=-1)
    return out.astype(x.dtype)


def _swa_with_sinks(q, k, v, sinks):
    B, S = q.shape[0], q.shape[1]
    nb = S // BLOCK
    qb = q.reshape(B, nb, BLOCK, N_KV_HEADS, Q_PER_KV, HEAD_DIM)
    kb = k.reshape(B, nb, BLOCK, N_KV_HEADS, HEAD_DIM)
    vb = v.reshape(B, nb, BLOCK, N_KV_HEADS, HEAD_DIM)

    def with_prev(t):
        prev = jnp.pad(t[:, :-1], ((0, 0), (1, 0), (0, 0), (0, 0), (0, 0)))
        return jnp.concatenate([prev, t], axis=2)

    kw, vw = with_prev(kb), with_prev(vb)
    scale = HEAD_DIM ** -0.5
    logits = jnp.einsum('bnqkgd,bnskd->bnkgqs', qb, kw,
                        preferred_element_type=jnp.float32) * scale
    blk = jnp.arange(nb)[:, None, None]
    qi = jnp.arange(BLOCK)[None, :, None]
    kj = jnp.arange(2 * BLOCK)[None, None, :]
    rel = BLOCK + qi - kj
    kpos = (blk - 1) * BLOCK + kj
    mask = (rel >= 0) & (rel < WINDOW) & (kpos >= 0)
    logits = jnp.where(mask[None, :, None, None], logits, -jnp.inf)
    sink = sinks.astype(jnp.float32).reshape(N_KV_HEADS, Q_PER_KV)[None, None, :, :, None, None]
    m = jnp.maximum(jnp.max(logits, axis=-1, keepdims=True), sink)
    p = jnp.exp(logits - m)
    denom = jnp.sum(p, axis=-1, keepdims=True) + jnp.exp(sink - m)
    probs = (p / denom).astype(v.dtype)
    out = jnp.einsum('bnkgqs,bnskd->bnqkgd', probs, vw)
    return out.reshape(B, S, ATTN_WIDTH)


def _multiscale_pool(u, w_pool, pool_scale):
    B, S = u.shape[0], u.shape[1]
    ug = u.reshape(B, S, N_POOL_GROUPS, POOL_GROUP_DIM).astype(jnp.float32)
    c = jnp.pad(jnp.cumsum(ug, axis=1), ((0, 0), (1, 0), (0, 0), (0, 0)))
    t = jnp.arange(S)
    means = []
    for g, w in enumerate(POOL_WINDOWS):
        cg = c[:, :, g]
        lagged = jnp.pad(cg[:, :S + 1 - w], ((0, 0), (w - 1, 0), (0, 0)))
        cnt = jnp.minimum(t + 1, w).astype(jnp.float32)[None, :, None]
        means.append((cg[:, 1:] - lagged) / cnt)
    mean = jnp.stack(means, axis=2)
    d = (mean - ug).astype(u.dtype)
    y = jnp.einsum('bsgc,gcd->bsgd', d, w_pool)
    return y.reshape(B, S, POOL_WIDTH) * pool_scale


def setup_inputs(seed: int = 0) -> dict:
    key = jax.random.key(seed)
    ks = jax.random.split(key, 12)
    f32 = jnp.float32
    x = jax.random.normal(ks[0], (BATCH, SEQ, D_MODEL), f32)
    attn_norm_g = 1.0 + 0.02 * jax.random.normal(ks[1], (DEPTH, D_MODEL), f32)
    w_in = jax.random.normal(ks[2], (DEPTH, D_MODEL, IN_WIDTH), f32) * D_MODEL ** -0.5
    attn_sinks = 0.5 * jax.random.normal(ks[3], (DEPTH, N_Q_HEADS), f32)
    w_pool = jax.random.normal(ks[4], (DEPTH, N_POOL_GROUPS, POOL_GROUP_DIM, POOL_GROUP_DIM), f32) * POOL_GROUP_DIM ** -0.5
    pool_scale = 1.0 + 0.1 * jax.random.normal(ks[5], (DEPTH, POOL_WIDTH), f32)
    w_out = jax.random.normal(ks[6], (DEPTH, MIX_WIDTH, D_MODEL), f32) * MIX_WIDTH ** -0.5
    mlp_norm_g = 1.0 + 0.02 * jax.random.normal(ks[7], (DEPTH, D_MODEL), f32)
    w_up = jax.random.normal(ks[8], (DEPTH, D_MODEL, D_FF), f32) * D_MODEL ** -0.5
    w_down = jax.random.normal(ks[9], (DEPTH, D_FF, D_MODEL), f32) * D_FF ** -0.5
    final_norm_g = 1.0 + 0.02 * jax.random.normal(ks[10], (D_MODEL,), f32)
    return {"x": x, "attn_norm_g": attn_norm_g, "w_in": w_in, "attn_sinks": attn_sinks,
            "w_pool": w_pool, "pool_scale": pool_scale, "w_out": w_out,
            "mlp_norm_g": mlp_norm_g, "w_up": w_up, "w_down": w_down,
            "final_norm_g": final_norm_g}


def reference(x, attn_norm_g, w_in, attn_sinks, w_pool, pool_scale, w_out,
              mlp_norm_g, w_up, w_down, final_norm_g):
    B, S = x.shape[0], x.shape[1]
    pos = jnp.arange(S)
    for l in range(DEPTH):
        h = _rmsnorm(x, attn_norm_g[l])
        proj = h @ w_in[l]
        q = proj[..., :ATTN_WIDTH].reshape(B, S, N_Q_HEADS, HEAD_DIM)
        k = proj[..., ATTN_WIDTH:ATTN_WIDTH + KV_WIDTH].reshape(B, S, N_KV_HEADS, HEAD_DIM)
        v = proj[..., ATTN_WIDTH + KV_WIDTH:ATTN_WIDTH + 2 * KV_WIDTH].reshape(B, S, N_KV_HEADS, HEAD_DIM)
        u = proj[..., ATTN_WIDTH + 2 * KV_WIDTH:]
        q, k = _rope(q, pos), _rope(k, pos)
        attn = _swa_with_sinks(q, k, v, attn_sinks[l])
        pool = _multiscale_pool(u, w_pool[l], pool_scale[l])
        x = x + jnp.concatenate([attn, pool], axis=-1) @ w_out[l]
        h = _rmsnorm(x, mlp_norm_g[l])
        x = x + jnp.square(jax.nn.relu(h @ w_up[l])) @ w_down[l]
    return _rmsnorm(x, final_norm_g)
```

```cpp
#include <hip/hip_runtime.h>
#include <cstdio>
#include <cstdint>

namespace pg8 {
#define PG8_LAS __attribute__((address_space(3)))
typedef unsigned short bf16_t;
typedef short bf16x8 __attribute__((ext_vector_type(8)));
typedef float f32x4 __attribute__((ext_vector_type(4)));
typedef unsigned u32x4 __attribute__((ext_vector_type(4)));
typedef unsigned u32x2 __attribute__((ext_vector_type(2)));
constexpr int BM = 256, BK = 64, HALF = 128, HTB = HALF * BK * 2  , STAGE_BYTES = 8 * HTB, NXCD = 8, WGM = 8;

__host__ __device__ __forceinline__ int lds_byte(int r, int c) { const int st = (r >> 4) * 2 + (c >> 5), rr = r & 15, cc = c & 31, ob = rr * 64 + cc * 2; return st * 1024 + (ob ^ (((ob >> 9) & 1) << 5)); }
__host__ __device__ __forceinline__ void stage_rc(int b, int& R, int& C) { const int st = b / 1024, sb = b % 1024, swz = sb ^ (((sb >> 9) & 1) << 5); R = (st >> 1) * 16 + swz / 64; C = (st & 1) * 32 + (swz % 64) / 2; }
__host__ __device__ __forceinline__ int perm32(int rho) { const int n = rho >> 4, i = rho & 15; return 8 * (i >> 2) + 4 * n + (i & 3); }

struct Unit { int pm, pn; };
struct Gemm { const bf16_t* A; const bf16_t* Bt; int M, N, K; };

struct StaticOrder {
    int nM, nN, nwg, G, c;
    __host__ __device__ void init(int M, int N, int G_, int c_) { nM = M / BM; nN = N / BM; nwg = nM * nN; G = G_; c = c_; }
    __host__ __device__ bool next(int i, Unit& u) const {
        const long L = (long)i * G + c; if (L >= nwg) return false;
        int wgid = (int)L; { const int q = nwg / NXCD, r = nwg % NXCD, xcd = wgid % NXCD, off = wgid / NXCD; wgid = (xcd < r ? xcd * (q + 1) : r * (q + 1) + (xcd - r) * q) + off; }
        const int nig = WGM * nN, gid = wgid / nig, fm = gid * WGM, gsz = (nM - fm) < WGM ? (nM - fm) : WGM;
        u.pm = fm + ((wgid % nig) % gsz); u.pn = (wgid % nig) / gsz; return true;
    }
    __device__ __forceinline__ void a_ready(const Unit&) const {}
    __device__ __forceinline__ void done(const Unit&) const {}
};

__device__ __forceinline__ unsigned cvt_pk_bf16(float lo, float hi) { unsigned r; asm volatile("v_cvt_pk_bf16_f32 %0, %1, %2" : "=v"(r) : "v"(lo), "v"(hi)); return r; }

constexpr float QSCALE = 0.18033688011112042f;
constexpr float RMS_EPS = 1e-6f;

struct EpiInProj {
    static constexpr bool PERM = true, AFTER_DRAIN = false;
    bf16_t *Q, *Kb, *Vb, *U; const float* cs; const float* sn;
    __device__ __forceinline__ void operator()(const f32x4 (&acc)[2][2][4][2], const Unit& u, int wr, int wc, int fr, int fq) const {
        const int row0 = u.pm * BM + wr * 64 + fr; const int pn = u.pn;
        bf16_t* base; int ld, col; bool rope; float sc = 1.f;
        if (pn < 2)       { base = Q;  ld = 512; col = pn * 256 + wc * 64; rope = true; sc = QSCALE; }
        else if (pn == 2) { if (wc < 2) { base = Kb; ld = 128; col = wc * 64; rope = true; } else { base = Vb; ld = 128; col = (wc - 2) * 64; rope = false; } }
        else              { base = U;  ld = 512; col = (pn - 3) * 256 + wc * 64; rope = false; }
        col += 8 * fq;
        if (rope) {
#pragma unroll
            for (int ai = 0; ai < 2; ++ai)
#pragma unroll
                for (int m = 0; m < 4; ++m) { const int row = row0 + ai * HALF + m * 16; const int pos = row & 2047;
                    const f32x4 c0 = *(const f32x4*)(cs + pos * 32 + 8 * fq), c1 = *(const f32x4*)(cs + pos * 32 + 8 * fq + 4);
                    const f32x4 s0 = *(const f32x4*)(sn + pos * 32 + 8 * fq), s1 = *(const f32x4*)(sn + pos * 32 + 8 * fq + 4);
                    const f32x4 a0 = acc[ai][0][m][0], a1 = acc[ai][0][m][1], b0 = acc[ai][1][m][0], b1 = acc[ai][1][m][1];
                    const f32x4 o00 = (a0 * c0 - b0 * s0) * sc, o01 = (a1 * c1 - b1 * s1) * sc, o10 = (b0 * c0 + a0 * s0) * sc, o11 = (b1 * c1 + a1 * s1) * sc;
                    bf16_t* rowp = base + (size_t)row * ld + col;
                    u32x4 w; w.x = cvt_pk_bf16(o00[0], o00[1]); w.y = cvt_pk_bf16(o00[2], o00[3]); w.z = cvt_pk_bf16(o01[0], o01[1]); w.w = cvt_pk_bf16(o01[2], o01[3]);
                    *(u32x4*)(rowp) = w;
                    w.x = cvt_pk_bf16(o10[0], o10[1]); w.y = cvt_pk_bf16(o10[2], o10[3]); w.z = cvt_pk_bf16(o11[0], o11[1]); w.w = cvt_pk_bf16(o11[2], o11[3]);
                    *(u32x4*)(rowp + 32) = w; }
        } else {
#pragma unroll
            for (int ai = 0; ai < 2; ++ai)
#pragma unroll
                for (int m = 0; m < 4; ++m) { bf16_t* rowp = base + (size_t)(row0 + ai * HALF + m * 16) * ld + col;
#pragma unroll
                    for (int bj = 0; bj < 2; ++bj) { const f32x4 v0 = acc[ai][bj][m][0], v1 = acc[ai][bj][m][1];
                        u32x4 w; w.x = cvt_pk_bf16(v0[0], v0[1]); w.y = cvt_pk_bf16(v0[2], v0[3]); w.z = cvt_pk_bf16(v1[0], v1[1]); w.w = cvt_pk_bf16(v1[2], v1[3]);
                        *(u32x4*)(rowp + 32 * bj) = w; } }
        }
    }
};

template <bool WRITE_BF16> struct EpiResidual {
    static constexpr bool PERM = false, AFTER_DRAIN = false;
    const float* base; float* out; bf16_t* xb; float* ssq; int ldc;
    __device__ __forceinline__ void operator()(const f32x4 (&acc)[2][2][4][2], const Unit& u, int wr, int wc, int fr, int fq) const {
        const int col0 = u.pn * BM + wc * 32 + 4 * fq;
#pragma unroll
        for (int ai = 0; ai < 2; ++ai)
#pragma unroll
            for (int m = 0; m < 4; ++m) { const int row = u.pm * BM + ai * HALF + wr * 64 + m * 16 + fr; const size_t off = (size_t)row * ldc + col0; float s = 0.f;
#pragma unroll
                for (int bj = 0; bj < 2; ++bj)
#pragma unroll
                    for (int n = 0; n < 2; ++n) { const f32x4 bs = *(const f32x4*)(base + off + bj * HALF + n * 16); const f32x4 o = bs + acc[ai][bj][m][n];
                        *(f32x4*)(out + off + bj * HALF + n * 16) = o; s += (o[0] * o[0] + o[1] * o[1]) + (o[2] * o[2] + o[3] * o[3]);
                        if (WRITE_BF16) { u32x2 w; w.x = cvt_pk_bf16(o[0], o[1]); w.y = cvt_pk_bf16(o[2], o[3]); *(u32x2*)(xb + off + bj * HALF + n * 16) = w; } }
                s += __shfl_xor(s, 16); s += __shfl_xor(s, 32);
                if (fq == 0) ssq[(size_t)row * 16 + u.pn * 4 + wc] = s;
                if (m & 1) asm volatile("" ::: "memory"); }
    }
};

struct EpiUp {
    static constexpr bool PERM = true, AFTER_DRAIN = false;
    bf16_t* O; int ldc; const float* ssq;
    __device__ __forceinline__ void operator()(const f32x4 (&acc)[2][2][4][2], const Unit& u, int wr, int wc, int fr, int fq) const {
        const int row0 = u.pm * BM + wr * 64 + fr; const int col0 = u.pn * BM + wc * 32 + 8 * fq;
#pragma unroll
        for (int ai = 0; ai < 2; ++ai)
#pragma unroll
            for (int m = 0; m < 4; ++m) { const int row = row0 + ai * HALF + m * 16; const f32x4* sp = (const f32x4*)(ssq + (size_t)row * 16);
                const f32x4 p0 = sp[0], p1 = sp[1], p2 = sp[2], p3 = sp[3];
                const float ss = ((p0[0] + p0[1]) + (p0[2] + p0[3])) + ((p1[0] + p1[1]) + (p1[2] + p1[3])) + ((p2[0] + p2[1]) + (p2[2] + p2[3])) + ((p3[0] + p3[1]) + (p3[2] + p3[3]));
                const float rs = 1.0f / sqrtf(ss * (1.0f / 1024.0f) + RMS_EPS);
                bf16_t* rowp = O + (size_t)row * ldc + col0;
#pragma unroll
                for (int bj = 0; bj < 2; ++bj) { f32x4 v0 = acc[ai][bj][m][0] * rs, v1 = acc[ai][bj][m][1] * rs;
#pragma unroll
                    for (int e = 0; e < 4; ++e) { const float a = fmaxf(v0[e], 0.f), b = fmaxf(v1[e], 0.f); v0[e] = a * a; v1[e] = b * b; }
                    u32x4 w; w.x = cvt_pk_bf16(v0[0], v0[1]); w.y = cvt_pk_bf16(v0[2], v0[3]); w.z = cvt_pk_bf16(v1[0], v1[1]); w.w = cvt_pk_bf16(v1[2], v1[3]);
                    *(u32x4*)(rowp + bj * HALF) = w; } }
    }
};

template <class Epi, class Sched, bool ALIGN_EPI = false, bool SP2 = false, bool ROPEMAP = false>
__device__ __forceinline__ void gemm_phase(PG8_LAS unsigned char* lds, const Gemm g, const Sched& S, const Epi& E) {
    const int tid = threadIdx.x, wid = __builtin_amdgcn_readfirstlane(tid >> 6), lane = tid & 63, wr = wid >> 2, wc = wid & 3, fr = lane & 15, fq = lane >> 4;
    const int K = g.K, nt = K / BK;
    unsigned voffA[2], voffB[2];
#pragma unroll
    for (int i = 0; i < 2; ++i) { int R, C; stage_rc(tid * 16 + i * 8192, R, C);
        const int Rb = ROPEMAP ? (64 * (R >> 5) + perm32(R & 31)) : (Epi::PERM ? ((R & ~31) + perm32(R & 31)) : R);
        voffA[i] = (unsigned)(R * K + C) * 2u; voffB[i] = (unsigned)(Rb * K + C) * 2u; }
    const size_t kstep = (size_t)(BK * 2);
    const size_t hstep = (size_t)HALF * K * 2;
    const size_t hstepB = ROPEMAP ? (size_t)32 * K * 2 : hstep;
    const size_t tstep = 2 * hstep;
    const unsigned ldsw = (unsigned)wid * 1024u;
    const int aoff = lds_byte(wr * 64 + fr, fq * 8), boff = lds_byte(wc * 32 + fr, fq * 8);
#define PG8_SA(b, h) (((b) * 2 + (h)) * HTB)
#define PG8_SB(b, h) ((4 + (b) * 2 + (h)) * HTB)
#define PG8_STAGE(bufoff, gbase, voff) do { _Pragma("unroll") for (int _i = 0; _i < 2; ++_i) \
        __builtin_amdgcn_global_load_lds((const unsigned*)((const char*)(gbase) + (voff)[_i]), (PG8_LAS unsigned*)(lds + (bufoff) + ldsw + _i * 8192), 16, 0, 0); } while (0)
#define PG8_LDA(dst, b, h) do { _Pragma("unroll") for (int m = 0; m < 4; ++m) _Pragma("unroll") for (int k = 0; k < 2; ++k) dst[m][k] = *(const PG8_LAS bf16x8*)(lds + PG8_SA(b, h) + aoff + m * 2048 + k * 1024); } while (0)
#define PG8_LDB(dst, b, h) do { _Pragma("unroll") for (int n = 0; n < 2; ++n) _Pragma("unroll") for (int k = 0; k < 2; ++k) dst[n][k] = *(const PG8_LAS bf16x8*)(lds + PG8_SB(b, h) + boff + n * 2048 + k * 1024); } while (0)
#define PG8_MMA(ai, bj, At, Bt) do { __builtin_amdgcn_s_setprio(1); _Pragma("unroll") for (int m = 0; m < 4; ++m) _Pragma("unroll") for (int n = 0; n < 2; ++n) _Pragma("unroll") for (int k = 0; k < 2; ++k) \
        acc[ai][bj][m][n] = __builtin_amdgcn_mfma_f32_16x16x32_bf16(Bt[n][k], At[m][k], acc[ai][bj][m][n], 0, 0, 0); __builtin_amdgcn_s_setprio(0); } while (0)
#define PG8_WAIT_V(n) asm volatile("s_waitcnt vmcnt(" #n ")" ::: "memory")
#define PG8_WAIT_L(n) asm volatile("s_waitcnt lgkmcnt(" #n ")" ::: "memory")
#define PG8_BAR __builtin_amdgcn_s_barrier()
#define PG8_SCHED __builtin_amdgcn_sched_barrier(0)
    Unit cur, nxt; int ui = 0;
    if (!S.next(0, cur)) return;
    f32x4 acc[2][2][4][2];
#pragma unroll
    for (int a = 0; a < 2; ++a)
#pragma unroll
        for (int b = 0; b < 2; ++b)
#pragma unroll
            for (int m = 0; m < 4; ++m)
#pragma unroll
                for (int n = 0; n < 2; ++n) acc[a][b][m][n] = (f32x4){0.f, 0.f, 0.f, 0.f};
    bf16x8 At[4][2], B0[2][2], B1[2][2];
    const char* cA = (const char*)g.A + (size_t)cur.pm * tstep; const char* cB = (const char*)g.Bt + (size_t)cur.pn * tstep;
    S.a_ready(cur);
    if constexpr (SP2) {
        PG8_STAGE(PG8_SB(0, 0), cB, voffB); PG8_STAGE(PG8_SB(0, 1), cB + hstepB, voffB); PG8_STAGE(PG8_SA(0, 0), cA, voffA); PG8_STAGE(PG8_SA(0, 1), cA + hstep, voffA);
        if (wr == 1) PG8_BAR;
        PG8_WAIT_V(2); PG8_BAR;
        PG8_STAGE(PG8_SB(1, 0), cB + kstep, voffB); PG8_STAGE(PG8_SA(1, 0), cA + kstep, voffA); PG8_STAGE(PG8_SB(1, 1), cB + hstepB + kstep, voffB);
        PG8_WAIT_V(6); PG8_BAR;
    } else {
        PG8_STAGE(PG8_SB(0, 0), cB, voffB); PG8_STAGE(PG8_SA(0, 0), cA, voffA); PG8_STAGE(PG8_SB(0, 1), cB + hstepB, voffB); PG8_STAGE(PG8_SA(0, 1), cA + hstep, voffA);
        if (wr == 1) PG8_BAR;
        PG8_WAIT_V(4); PG8_BAR;
        PG8_STAGE(PG8_SB(1, 0), cB + kstep, voffB); PG8_STAGE(PG8_SA(1, 0), cA + kstep, voffA); PG8_STAGE(PG8_SB(1, 1), cB + hstepB + kstep, voffB);
        PG8_WAIT_V(6); PG8_BAR;
    }
    for (;;) {
        const bool has_next = S.next(ui + 1, nxt);
        const char* nA = has_next ? (const char*)g.A + (size_t)nxt.pm * tstep : cA; const char* nB = has_next ? (const char*)g.Bt + (size_t)nxt.pn * tstep : cB;
        for (int t = 0; t < nt; t += 2) {
            const bool last = (t == nt - 2);
            const char* a1 = cA + (size_t)(t + 1) * kstep;
            const char* a2 = last ? nA : cA + (size_t)(t + 2) * kstep; const char* b2 = last ? nB : cB + (size_t)(t + 2) * kstep;
            const char* a3 = a2 + kstep; const char* b3 = b2 + kstep;
            if (last && has_next) S.a_ready(nxt);
            if constexpr (SP2) {
            PG8_LDB(B0, 0, 0); PG8_LDB(B1, 0, 1); PG8_SCHED; PG8_LDA(At, 0, 0); PG8_STAGE(PG8_SA(1, 1), a1 + hstep, voffA);
            PG8_WAIT_V(8); PG8_WAIT_L(0); PG8_BAR; PG8_MMA(0, 0, At, B0); PG8_MMA(0, 1, At, B1); PG8_BAR; PG8_SCHED;
            PG8_LDA(At, 0, 1); PG8_STAGE(PG8_SB(0, 0), b2, voffB); PG8_STAGE(PG8_SB(0, 1), b2 + hstepB, voffB); PG8_STAGE(PG8_SA(0, 0), a2, voffA);
            PG8_WAIT_V(8); PG8_WAIT_L(0); PG8_BAR; PG8_MMA(1, 0, At, B0); PG8_MMA(1, 1, At, B1); PG8_BAR; PG8_SCHED;
            PG8_LDB(B0, 1, 0); PG8_LDB(B1, 1, 1); PG8_SCHED; PG8_LDA(At, 1, 0); PG8_STAGE(PG8_SA(0, 1), a2 + hstep, voffA);
            PG8_WAIT_V(8); PG8_WAIT_L(0); PG8_BAR; PG8_MMA(0, 0, At, B0); PG8_MMA(0, 1, At, B1); PG8_BAR; PG8_SCHED;
            PG8_LDA(At, 1, 1); PG8_STAGE(PG8_SB(1, 0), b3, voffB); PG8_STAGE(PG8_SB(1, 1), b3 + hstepB, voffB); PG8_STAGE(PG8_SA(1, 0), a3, voffA);
            PG8_WAIT_V(8); PG8_WAIT_L(0); PG8_BAR; PG8_MMA(1, 0, At, B0); PG8_MMA(1, 1, At, B1); PG8_BAR; PG8_SCHED;
            } else {
            PG8_LDB(B0, 0, 0); PG8_SCHED; PG8_LDA(At, 0, 0); PG8_STAGE(PG8_SA(1, 1), a1 + hstep, voffA);
            PG8_WAIT_L(8); PG8_BAR; PG8_WAIT_L(0); PG8_MMA(0, 0, At, B0); PG8_BAR; PG8_SCHED;
            PG8_LDB(B1, 0, 1); PG8_STAGE(PG8_SB(0, 0), b2, voffB);
            PG8_BAR; PG8_WAIT_L(0); PG8_MMA(0, 1, At, B1); PG8_BAR;
            PG8_LDA(At, 0, 1); PG8_STAGE(PG8_SA(0, 0), a2, voffA);
            PG8_BAR; PG8_WAIT_L(0); PG8_MMA(1, 0, At, B0); PG8_BAR; PG8_SCHED;
            PG8_STAGE(PG8_SB(0, 1), b2 + hstepB, voffB);
            PG8_WAIT_V(6); PG8_BAR; PG8_MMA(1, 1, At, B1); PG8_BAR;
            PG8_LDB(B0, 1, 0); PG8_SCHED; PG8_LDA(At, 1, 0); PG8_STAGE(PG8_SA(0, 1), a2 + hstep, voffA);
            PG8_WAIT_L(8); PG8_BAR; PG8_WAIT_L(0); PG8_MMA(0, 0, At, B0); PG8_BAR; PG8_SCHED;
            PG8_LDB(B1, 1, 1); PG8_STAGE(PG8_SB(1, 0), b3, voffB);
            PG8_BAR; PG8_WAIT_L(0); PG8_MMA(0, 1, At, B1); PG8_BAR;
            PG8_LDA(At, 1, 1); PG8_STAGE(PG8_SA(1, 0), a3, voffA);
            PG8_BAR; PG8_WAIT_L(0); PG8_MMA(1, 0, At, B0); PG8_BAR; PG8_SCHED;
            PG8_STAGE(PG8_SB(1, 1), b3 + hstepB, voffB);
            PG8_WAIT_V(6); PG8_BAR; PG8_MMA(1, 1, At, B1); PG8_BAR;
            }
        }
        if constexpr (ALIGN_EPI) { if (wr == 0) PG8_BAR; }
        if constexpr (!Epi::AFTER_DRAIN) { E(acc, cur, wr, wc, fr, fq); S.done(cur); }
        if (!has_next) break;
#pragma unroll
        for (int a = 0; a < 2; ++a)
#pragma unroll
            for (int b = 0; b < 2; ++b)
#pragma unroll
                for (int m = 0; m < 4; ++m)
#pragma unroll
                    for (int n = 0; n < 2; ++n) acc[a][b][m][n] = (f32x4){0.f, 0.f, 0.f, 0.f};
        cur = nxt; cA = nA; cB = nB; ++ui;
        if constexpr (ALIGN_EPI) { if (wr == 1) PG8_BAR; }
    }
    PG8_WAIT_V(0);
    if constexpr (!ALIGN_EPI) { if (wr == 0) PG8_BAR; }
    PG8_BAR;
#undef PG8_SA
#undef PG8_SB
#undef PG8_STAGE
#undef PG8_LDA
#undef PG8_LDB
#undef PG8_MMA
#undef PG8_WAIT_V
#undef PG8_WAIT_L
#undef PG8_BAR
#undef PG8_SCHED
}
}

#ifndef PG8_SP2
#define PG8_SP2 true
#endif
#ifndef PG8_ALIGN
#define PG8_ALIGN true
#endif

constexpr int NWAVES = 8;
#ifndef MK_N_LAUNCHES
#define MK_N_LAUNCHES 1
#endif
constexpr int N_LAUNCHES = MK_N_LAUNCHES;
constexpr int PER_PHASE = 7;

constexpr int BATCH = 32, SEQ = 2048, D = 1024, NIN = 1280, FF = 4096, HD = 64, NQH = 8, NKVH = 2, AW = 512, KVW = 128, PW = 512;
constexpr int M = BATCH * SEQ;

constexpr size_t MiB = 1u << 20;
constexpr size_t WS_CTL = 0, CTL_ZERO_BYTES = 1 * MiB;
constexpr size_t WS_WIN = 2 * MiB;
constexpr size_t WS_WO = 5 * MiB;
constexpr size_t WS_WUP = 8 * MiB;
constexpr size_t WS_WDN = 16 * MiB;
constexpr size_t WS_ROPE = 24 * MiB;
constexpr size_t WS_SSQ1 = 25 * MiB;
constexpr size_t WS_SSQ2 = 29 * MiB;
constexpr size_t WS_X1B = 40 * MiB;
constexpr size_t WS_H = 168 * MiB;
constexpr size_t WS_XN = 168 * MiB;
constexpr size_t WS_Q = 296 * MiB;
constexpr size_t WS_K = 360 * MiB;
constexpr size_t WS_V = 376 * MiB;
constexpr size_t WS_U = 392 * MiB;
constexpr size_t WS_A2 = 456 * MiB;
constexpr size_t WS_END = 680 * MiB;
static_assert(WS_A2 + (size_t)M * 1024 * 2 <= WS_END && WS_H + (size_t)M * FF * 2 <= WS_END && WS_X1B + (size_t)M * D * 2 <= WS_H, "d_ws map");
constexpr int CW_BAR = 4096;

constexpr int RING_OFF = 0, RING_BYTES = 131072;
constexpr int LDSCTL_OFF = RING_BYTES, MISC_OFF = LDSCTL_OFF + 320;
constexpr int LDS_BYTES = 147456;

#define GAS __attribute__((address_space(1)))
#define LAS __attribute__((address_space(3)))
typedef unsigned short bf16;
typedef unsigned v4u __attribute__((ext_vector_type(4)));
typedef unsigned v2u __attribute__((ext_vector_type(2)));
typedef float f32x4 __attribute__((ext_vector_type(4)));
typedef float f32x16 __attribute__((ext_vector_type(16)));
typedef short bf16x8 __attribute__((ext_vector_type(8)));
typedef short s16x4 __attribute__((ext_vector_type(4)));
typedef GAS unsigned gu32;
#define RLX_AGENT __ATOMIC_RELAXED, __HIP_MEMORY_SCOPE_AGENT
#define LDS_WAIT() asm volatile("s_waitcnt lgkmcnt(0)" ::: "memory")
#define VM_WAIT() asm volatile("s_waitcnt vmcnt(0)" ::: "memory")
__device__ __forceinline__ unsigned f2bf(float f) { unsigned u = __builtin_bit_cast(unsigned, f); return (u + 0x7fffu + ((u >> 16) & 1u)) >> 16; }
__device__ __forceinline__ unsigned pk2(float lo, float hi) { return f2bf(lo) | (f2bf(hi) << 16); }
__device__ __forceinline__ float bflo(unsigned w) { return __builtin_bit_cast(float, w << 16); }
__device__ __forceinline__ float bfhi(unsigned w) { return __builtin_bit_cast(float, w & 0xffff0000u); }

#define XB_TMO      128
#define XB_XCNT(j)  (256  + 64 * (j))
#define XB_XSUB(j)  (1280 + 64 * (j))
#define XB_XGEN(j)  (2304 + 64 * (j))
#define XB_TOP      3328
#define XB_TOPGEN   3392
#define XCD_BAR_WORDS 3456
#define XB_SPIN_CAP (1u << 18)

__device__ __forceinline__ unsigned xb_ld(unsigned* p)              { return __hip_atomic_load(p, __ATOMIC_RELAXED, __HIP_MEMORY_SCOPE_AGENT); }
__device__ __forceinline__ unsigned xb_add(unsigned* p, unsigned v) { return __hip_atomic_fetch_add(p, v, __ATOMIC_RELAXED, __HIP_MEMORY_SCOPE_AGENT); }
__device__ __forceinline__ unsigned xb_xcc_id() { return (unsigned)__builtin_amdgcn_s_getreg((3 << 11) | 20) & 0xFu; }
#define XB_SPIN(cond, bar) do { unsigned _sp = 0; while (cond) { __builtin_amdgcn_s_sleep(1); \
    if ((++_sp & 255u) == 0u) { if (xb_ld(&(bar)[XB_TMO])) break; if (_sp > XB_SPIN_CAP) { atomicAdd(&(bar)[XB_TMO], 1u); break; } } } } while (0)

struct XcdBarrier { unsigned* bar; unsigned x; volatile LAS unsigned* st; };

__device__ __forceinline__ XcdBarrier xcd_barrier_post(unsigned* bar, volatile LAS unsigned* st) {
    XcdBarrier b; b.bar = bar; b.x = xb_xcc_id(); b.st = st;
    if (threadIdx.x == 0) (void)xb_add(&bar[XB_XCNT(b.x)], 1u);
    return b;
}
__device__ __forceinline__ void xcd_barrier_complete(unsigned* bar, unsigned x, unsigned& nloc, unsigned& nx) {
    const unsigned G = gridDim.x * gridDim.y * gridDim.z;
    unsigned sum, cnt, mine, sp = 0u;
    for (;;) {
        sum = 0u; cnt = 0u; mine = 0u;
#pragma unroll
        for (unsigned j = 0; j < 16; ++j) { const unsigned c = xb_ld(&bar[XB_XCNT(j)]); sum += c; cnt += (c > 0u) ? 1u : 0u; mine = (j == x) ? c : mine; }
        if (sum == G) break;
        __builtin_amdgcn_s_sleep(1);
        if ((++sp & 255u) == 0u) { if (xb_ld(&bar[XB_TMO])) break; if (sp > XB_SPIN_CAP) { atomicAdd(&bar[XB_TMO], 1u); break; } }
    }
    nloc = mine > 0u ? mine : 1u; nx = cnt > 0u ? cnt : 1u;
}
__device__ __forceinline__ void xcd_barrier(const XcdBarrier& b) {
    asm volatile("s_waitcnt vmcnt(0)" ::: "memory");
    __syncthreads();
    if (threadIdx.x == 0) {
        unsigned* bar = b.bar;
        __builtin_amdgcn_s_waitcnt(0);
        unsigned nloc = b.st[0], nx = b.st[1];
        if (nloc == 0u) { xcd_barrier_complete(bar, b.x, nloc, nx); b.st[0] = nloc; b.st[1] = nx; }
        const unsigned old = xb_add(&bar[XB_XSUB(b.x)], 1u);
        const unsigned gen = old / nloc;
        if (old + 1u == (gen + 1u) * nloc) {
            __builtin_amdgcn_fence(__ATOMIC_RELEASE, "agent");
            asm volatile("s_waitcnt vmcnt(0)" ::: "memory");
            const unsigned og = xb_add(&bar[XB_TOP], 1u);
            const unsigned tg = og / nx;
            if (og + 1u == (tg + 1u) * nx) xb_add(&bar[XB_TOPGEN], 1u);
            else XB_SPIN(xb_ld(&bar[XB_TOPGEN]) == tg, bar);
            __builtin_amdgcn_fence(__ATOMIC_ACQUIRE, "agent");
            xb_add(&bar[XB_XGEN(b.x)], 1u);
            asm volatile("s_waitcnt vmcnt(0)" ::: "memory");
        } else {
            XB_SPIN(xb_ld(&bar[XB_XGEN(b.x)]) == gen, bar);
            __builtin_amdgcn_fence(__ATOMIC_ACQUIRE, "agent");
            asm volatile("s_waitcnt vmcnt(0)" ::: "memory");
        }
    }
    __syncthreads();
}

struct Frame {
    LAS unsigned char* lds;
    volatile LAS unsigned* MISC;
    gu32* ctl;
    int tid, lane, wave;
    int vcu, G;
};

__device__ __forceinline__ float wave_sum(float v) {
#pragma unroll
    for (int o = 1; o < 64; o <<= 1) v += __shfl_xor(v, o);
    return v;
}

__device__ __forceinline__ void p0_transpose_item(const float* W, int N, const float* gain, bf16* WT, int ldwt, LAS float* scr, int item, int lane) {
    const int nblk = N / 32, kb = item / nblk, nb = item % nblk, k0 = 64 * kb, n0 = 32 * nb;
#pragma unroll 8
    for (int i = 0; i < 32; ++i) { const int kk = 2 * i + (lane >> 5); const float gsc = gain ? gain[k0 + kk] : 1.0f; scr[kk * 33 + (lane & 31)] = W[(size_t)(k0 + kk) * N + n0 + (lane & 31)] * gsc; }
    LDS_WAIT(); asm volatile("" ::: "memory");
    const int c = lane & 7;
#pragma unroll
    for (int j = 0; j < 4; ++j) { const int n = (lane >> 3) + 8 * j; const LAS float* s = scr + (8 * c) * 33 + n;
        v4u o; o.x = pk2(s[0 * 33], s[1 * 33]); o.y = pk2(s[2 * 33], s[3 * 33]); o.z = pk2(s[4 * 33], s[5 * 33]); o.w = pk2(s[6 * 33], s[7 * 33]);
        *(GAS v4u*)(WT + (size_t)(n0 + n) * ldwt + k0 + 8 * c) = o; }
    LDS_WAIT(); asm volatile("" ::: "memory");
}
__device__ __forceinline__ void p0_fold_item(const float* wp, const float* ps, const float* wout, bf16* WoT, int task, int lane) {
    const int nb = task & 15, g = (task >> 4) & 3, c0 = (task >> 6) * 8, n = nb * 64 + lane;
    float a[8];
#pragma unroll
    for (int i = 0; i < 8; ++i) a[i] = 0.f;
    const float* wrow = wout + (size_t)(512 + 128 * g) * D + n;
    const float* wpg = wp + (size_t)(g * 128 + c0) * 128;
    for (int d = 0; d < 128; ++d) { const float v = ps[128 * g + d] * wrow[(size_t)d * D];
#pragma unroll
        for (int i = 0; i < 8; ++i) a[i] += wpg[i * 128 + d] * v; }
    v4u o; o.x = pk2(a[0], a[1]); o.y = pk2(a[2], a[3]); o.z = pk2(a[4], a[5]); o.w = pk2(a[6], a[7]);
    *(GAS v4u*)(WoT + (size_t)n * D + 512 + 128 * g + c0) = o;
}
__device__ __forceinline__ void p0_rope_entry(float* cs, float* sn, int idx) {
    const int pos = idx >> 5, i = idx & 31;
    double w = 1.0; for (int j = 0; j < i; ++j) w *= 0.7498942093324559;
    const float inv_freq = (float)w; const float angf = (float)pos * inv_freq;
    const double ang = (double)angf; const double kq = __builtin_rint(ang * 0.6366197723675814);
    double r = ang - kq * 1.5707963267948966; r -= kq * 6.123233995736766e-17;
    const double r2 = r * r;
    double sp = -1.0 / 1307674368000.0;
    sp = sp * r2 + 1.0 / 6227020800.0; sp = sp * r2 - 1.0 / 39916800.0; sp = sp * r2 + 1.0 / 362880.0; sp = sp * r2 - 1.0 / 5040.0; sp = sp * r2 + 1.0 / 120.0; sp = sp * r2 - 1.0 / 6.0; sp = sp * r2 + 1.0;
    const double sr = sp * r;
    double cp = 1.0 / 20922789888000.0;
    cp = cp * r2 - 1.0 / 87178291200.0; cp = cp * r2 + 1.0 / 479001600.0; cp = cp * r2 - 1.0 / 3628800.0; cp = cp * r2 + 1.0 / 40320.0; cp = cp * r2 - 1.0 / 720.0; cp = cp * r2 + 1.0 / 24.0; cp = cp * r2 - 0.5; cp = cp * r2 + 1.0;
    const int q = ((int)kq) & 3;
    const double c = (q == 0) ? cp : (q == 1) ? -sr : (q == 2) ? -cp : sr;
    const double s = (q == 0) ? sr : (q == 1) ? cp : (q == 2) ? -sr : -cp;
    cs[idx] = (float)c; sn[idx] = (float)s;
}
__device__ __forceinline__ void rms_row_to_bf16(const float* xrow, bf16* orow, int lane) {
    const GAS f32x4* xr = (const GAS f32x4*)xrow + lane;
    f32x4 v[4]; float s = 0.f;
#pragma unroll
    for (int j = 0; j < 4; ++j) { v[j] = xr[64 * j]; s += (v[j].x * v[j].x + v[j].y * v[j].y) + (v[j].z * v[j].z + v[j].w * v[j].w); }
    const float rstd = 1.f / sqrtf(wave_sum(s) * (1.f / D) + pg8::RMS_EPS);
    GAS unsigned long long* o8 = (GAS unsigned long long*)orow + lane;
#pragma unroll
    for (int j = 0; j < 4; ++j) o8[64 * j] = (unsigned long long)pk2(v[j].x * rstd, v[j].y * rstd) | ((unsigned long long)pk2(v[j].z * rstd, v[j].w * rstd) << 32);
}

__device__ __forceinline__ void pool_rows(const bf16* U, bf16* A2, int row_lo, int nrows, int lane) {
    const int g = lane >> 4, w = 2 << g;
    for (int rr = 0; rr < nrows; ++rr) {
        const int t = row_lo + rr, pos = t & (SEQ - 1); const int cnt = (pos + 1) < w ? (pos + 1) : w;
        float a[8];
#pragma unroll
        for (int i = 0; i < 8; ++i) a[i] = 0.f;
        v4u self = *(const GAS v4u*)(U + (size_t)t * PW + 8 * lane);
#pragma unroll
        for (int j = 0; j < 16; ++j) { const bool ok = j < cnt; const int tj = ok ? t - j : t;
            const v4u v = *(const GAS v4u*)(U + (size_t)tj * PW + 8 * lane); const float m = ok ? 1.f : 0.f;
            a[0] += m * bflo(v.x); a[1] += m * bfhi(v.x); a[2] += m * bflo(v.y); a[3] += m * bfhi(v.y); a[4] += m * bflo(v.z); a[5] += m * bfhi(v.z); a[6] += m * bflo(v.w); a[7] += m * bfhi(v.w); }
        const float ic = 1.0f / (float)cnt;
        v4u o; o.x = pk2(a[0] * ic - bflo(self.x), a[1] * ic - bfhi(self.x)); o.y = pk2(a[2] * ic - bflo(self.y), a[3] * ic - bfhi(self.y));
        o.z = pk2(a[4] * ic - bflo(self.z), a[5] * ic - bfhi(self.z)); o.w = pk2(a[6] * ic - bflo(self.w), a[7] * ic - bfhi(self.w));
        *(GAS v4u*)(A2 + (size_t)t * 1024 + 512 + 8 * lane) = o;
    }
}

__device__ __forceinline__ int bitrev3(int x) { return ((x & 1) << 2) | (x & 2) | ((x >> 2) & 1); }
__device__ __forceinline__ int kv_off(int row, int chunk) { return row * 128 + ((chunk ^ bitrev3((row >> 1) & 7)) << 4); }
__device__ __forceinline__ s16x4 vtr(const LAS unsigned char* p) { typedef short v4i16_t __attribute__((ext_vector_type(4))); return __builtin_bit_cast(s16x4, __builtin_amdgcn_ds_read_tr16_b64_v4i16((LAS v4i16_t*)p)); }
constexpr int ATT_KOFF = 0, ATT_VOFF = 32768;
__device__ __forceinline__ void attn_unit(LAS unsigned char* lds, int b, int n, int kvh, const bf16* Q, const bf16* Kb, const bf16* Vb, bf16* A2, const float* sinks, int tid, int wid, int lane) {
    const long seq0 = (long)b * SEQ; const int kpos0 = 128 * (n - 1);
    {
        v4u kr[4], vr[4];
#pragma unroll
        for (int p = 0; p < 4; ++p) { const int row = (tid >> 3) + 64 * p, ch = tid & 7; int pos = kpos0 + row; pos = pos < 0 ? 0 : pos;
            kr[p] = *(const GAS v4u*)(Kb + (size_t)(seq0 + pos) * KVW + kvh * HD + ch * 8); vr[p] = *(const GAS v4u*)(Vb + (size_t)(seq0 + pos) * KVW + kvh * HD + ch * 8); }
#pragma unroll
        for (int p = 0; p < 4; ++p) { const int row = (tid >> 3) + 64 * p, ch = tid & 7;
            *(LAS v4u*)(lds + ATT_KOFF + kv_off(row, ch)) = kr[p]; *(LAS v4u*)(lds + ATT_VOFF + kv_off(row, ch)) = vr[p]; }
    }
    __syncthreads();
    const int i32 = lane & 31, h = lane >> 5;
    const int hq = 4 * kvh + (wid >> 1);
    const float sink2 = sinks[hq] * 1.4426950408889634f;
    int kaddr[4];
#pragma unroll
    for (int s = 0; s < 4; ++s) kaddr[s] = ATT_KOFF + kv_off(i32, 2 * s + h);
    const int dsub = (lane >> 4) & 1, qrow = (lane & 15) >> 2, pp = lane & 3;
    int vaddr1[2], vaddr2[2];
#pragma unroll
    for (int d0 = 0; d0 < 2; ++d0) { const int c = 4 * d0 + 2 * dsub + (pp >> 1); vaddr1[d0] = ATT_VOFF + kv_off(4 * h + qrow, c) + 8 * (pp & 1); vaddr2[d0] = ATT_VOFF + kv_off(4 * h + qrow + 8, c) + 8 * (pp & 1); }
    const float NEG = -INFINITY;
    for (int qq = 0; qq < 2; ++qq) {
        const int q0 = 32 * (2 * (wid & 1) + qq);
        const size_t qg = (size_t)(seq0 + 128 * n + q0 + i32);
        bf16x8 qf[4];
#pragma unroll
        for (int s = 0; s < 4; ++s) qf[s] = *(const GAS bf16x8*)(Q + qg * AW + hq * HD + 16 * s + 8 * h);
        f32x16 S[5];
        const int ih = i32 - 4 * h;
#pragma unroll
        for (int t = 0; t < 5; ++t) {
            const bool dead = (n == 0) && (q0 + 32 * t < 128);
#pragma unroll
            for (int r = 0; r < 16; ++r) S[t][r] = 0.f;
            if (!dead) {
#pragma unroll
                for (int s = 0; s < 4; ++s) { const bf16x8 kf = *(const LAS bf16x8*)(lds + kaddr[s] + (q0 + 32 * t) * 128); S[t] = __builtin_amdgcn_mfma_f32_32x32x16_bf16(kf, qf[s], S[t], 0, 0, 0); }
            }
#pragma unroll
            for (int r = 0; r < 16; ++r) { const int cr = (r & 3) + 8 * (r >> 2);
                bool ok = !dead;
                if (t == 0) ok = ok && (cr > ih);
                if (t == 4) ok = ok && (cr <= ih);
                S[t][r] = ok ? S[t][r] : NEG; }
        }
        float mx = sink2;
#pragma unroll
        for (int t = 0; t < 5; ++t)
#pragma unroll
            for (int r = 0; r < 16; ++r) mx = fmaxf(mx, S[t][r]);
        mx = fmaxf(mx, __shfl_xor(mx, 32));
        float l = 0.f;
#pragma unroll
        for (int t = 0; t < 5; ++t)
#pragma unroll
            for (int r = 0; r < 16; ++r) { const float p = __builtin_amdgcn_exp2f(S[t][r] - mx); S[t][r] = p; l += p; }
        l += __shfl_xor(l, 32);
        l += __builtin_amdgcn_exp2f(sink2 - mx);
        const float inv = 1.0f / l;
        f32x16 O[2];
#pragma unroll
        for (int r = 0; r < 16; ++r) { O[0][r] = 0.f; O[1][r] = 0.f; }
#pragma unroll
        for (int t = 0; t < 5; ++t) {
            const bool dead = (n == 0) && (q0 + 32 * t < 128);
            if (!dead) {
#pragma unroll
                for (int s2 = 0; s2 < 2; ++s2) {
                    v4u pw; pw.x = pg8::cvt_pk_bf16(S[t][8 * s2 + 0], S[t][8 * s2 + 1]); pw.y = pg8::cvt_pk_bf16(S[t][8 * s2 + 2], S[t][8 * s2 + 3]);
                    pw.z = pg8::cvt_pk_bf16(S[t][8 * s2 + 4], S[t][8 * s2 + 5]); pw.w = pg8::cvt_pk_bf16(S[t][8 * s2 + 6], S[t][8 * s2 + 7]);
                    const bf16x8 pf = __builtin_bit_cast(bf16x8, pw);
                    const int ro = (q0 + 32 * t + 16 * s2) * 128;
#pragma unroll
                    for (int d0 = 0; d0 < 2; ++d0) { const s16x4 lo = vtr(lds + vaddr1[d0] + ro), hi = vtr(lds + vaddr2[d0] + ro);
                        const bf16x8 vf = (bf16x8){lo[0], lo[1], lo[2], lo[3], hi[0], hi[1], hi[2], hi[3]};
                        O[d0] = __builtin_amdgcn_mfma_f32_32x32x16_bf16(vf, pf, O[d0], 0, 0, 0); }
                }
            }
        }
        bf16* orow = A2 + qg * 1024 + hq * HD + 4 * h;
#pragma unroll
        for (int d0 = 0; d0 < 2; ++d0)
#pragma unroll
            for (int rg = 0; rg < 4; ++rg) { v2u w; w.x = pg8::cvt_pk_bf16(O[d0][4 * rg] * inv, O[d0][4 * rg + 1] * inv); w.y = pg8::cvt_pk_bf16(O[d0][4 * rg + 2] * inv, O[d0][4 * rg + 3] * inv);
                *(GAS v2u*)(orow + 32 * d0 + 8 * rg) = w; }
    }
    __syncthreads();
}

struct Args { const float* in[11]; float* out; unsigned char* ws; int ph_lo, ph_hi, li, pad; };
__global__ void __launch_bounds__(NWAVES * 64, 2) hymba_fwd(Args args) {
    extern __shared__ __attribute__((aligned(16))) unsigned char lds[];
    Frame F;
    F.lds = (LAS unsigned char*)lds;
    F.MISC = (volatile LAS unsigned*)(F.lds + MISC_OFF);
    F.tid = threadIdx.x; F.lane = F.tid & 63; F.wave = __builtin_amdgcn_readfirstlane(F.tid >> 6);
    F.G = gridDim.x; { const int bx = blockIdx.x; F.vcu = (F.G % 8 == 0) ? (bx % 8) * (F.G / 8) + bx / 8 : bx; }
    unsigned char* ws = args.ws;
    F.ctl = (gu32*)(ws + WS_CTL);
    const float* x = args.in[0]; const float* g1 = args.in[1]; const float* w_in = args.in[2]; const float* sinks = args.in[3]; const float* w_pool = args.in[4];
    const float* pool_scale = args.in[5]; const float* w_out = args.in[6]; const float* g2 = args.in[7]; const float* w_up = args.in[8]; const float* w_down = args.in[9]; const float* g3 = args.in[10];
    float* out = args.out;
    bf16* WinT = (bf16*)(ws + WS_WIN); bf16* WoT = (bf16*)(ws + WS_WO); bf16* WupT = (bf16*)(ws + WS_WUP); bf16* WdnT = (bf16*)(ws + WS_WDN);
    float* rope_cs = (float*)(ws + WS_ROPE); float* rope_sn = rope_cs + SEQ * 32;
    float* ssq1 = (float*)(ws + WS_SSQ1); float* ssq2 = (float*)(ws + WS_SSQ2);
    bf16* X1B = (bf16*)(ws + WS_X1B); bf16* HB = (bf16*)(ws + WS_H); bf16* XN = (bf16*)(ws + WS_XN);
    bf16* QB = (bf16*)(ws + WS_Q); bf16* KB = (bf16*)(ws + WS_K); bf16* VB = (bf16*)(ws + WS_V); bf16* UB = (bf16*)(ws + WS_U); bf16* A2 = (bf16*)(ws + WS_A2);

    for (int u = F.tid; u < (LDS_BYTES - LDSCTL_OFF) / 4; u += NWAVES * 64) ((LAS unsigned*)(F.lds + LDSCTL_OFF))[u] = 0u;
    __syncthreads();
    XcdBarrier bar; bar.bar = (unsigned*)(F.ctl + CW_BAR); bar.x = 0; bar.st = nullptr;
    if (N_LAUNCHES != PER_PHASE) bar = xcd_barrier_post((unsigned*)(F.ctl + CW_BAR), F.MISC + 8);
#define GRID_BAR() do { if (N_LAUNCHES != PER_PHASE) xcd_barrier(bar); } while (0)
    const int lo = args.ph_lo, hi = args.ph_hi;
#define IN(k) (lo <= (k) && (k) < hi)
#define BOTH(k) (IN(k) && IN((k) + 1))
    const int gw = F.vcu * NWAVES + F.wave, NGW = F.G * NWAVES;

    if (IN(0)) {
        LAS float* scr = (LAS float*)(F.lds + RING_OFF + F.wave * 16384);
        constexpr int I_IN = (D / 64) * (NIN / 32), I_O = (512 / 64) * (D / 32), I_UP = (D / 64) * (FF / 32), I_DN = (FF / 64) * (D / 32), I_FOLD = 1024, I_ROPE = SEQ * 32 / 64;
        constexpr int NITEMS = I_IN + I_O + I_UP + I_DN + I_FOLD + I_ROPE;
        for (int it = gw; it < NITEMS; it += NGW) {
            int r = it;
            if (r < I_IN) { p0_transpose_item(w_in, NIN, g1, WinT, D, scr, r, F.lane); continue; } r -= I_IN;
            if (r < I_O)  { p0_transpose_item(w_out, D, nullptr, WoT, D, scr, r, F.lane); continue; } r -= I_O;
            if (r < I_UP) { p0_transpose_item(w_up, FF, g2, WupT, D, scr, r, F.lane); continue; } r -= I_UP;
            if (r < I_DN) { p0_transpose_item(w_down, D, nullptr, WdnT, FF, scr, r, F.lane); continue; } r -= I_DN;
            if (r < I_FOLD) { p0_fold_item(w_pool, pool_scale, w_out, WoT, r, F.lane); continue; } r -= I_FOLD;
            p0_rope_entry(rope_cs, rope_sn, r * 64 + F.lane);
        }
        for (int m = gw; m < M; m += NGW) rms_row_to_bf16(x + (size_t)m * D, XN + (size_t)m * D, F.lane);
        if (BOTH(0)) GRID_BAR();
    }

    if (IN(1)) {
        pg8::Gemm g{XN, WinT, M, NIN, D}; pg8::StaticOrder S; S.init(M, NIN, F.G, (int)blockIdx.x);
        pg8::EpiInProj E{QB, KB, VB, UB, rope_cs, rope_sn};
        pg8::gemm_phase<pg8::EpiInProj, pg8::StaticOrder, PG8_ALIGN, PG8_SP2, true>(F.lds + RING_OFF, g, S, E);
        if (BOTH(1)) GRID_BAR();
    }

    if (IN(2)) {
        for (int ch = gw; ch < M / 32; ch += NGW) pool_rows(UB, A2, ch * 32, 32, F.lane);
        for (int u0 = F.vcu; u0 < BATCH * 16 * 2 / 4; u0 += F.G)
            for (int i = 0; i < 4; ++i) { const int uid = u0 * 4 + i;
                attn_unit(F.lds + RING_OFF, uid >> 5, uid & 15, (uid >> 4) & 1, QB, KB, VB, A2, sinks, F.tid, F.wave, F.lane); }
        if (BOTH(2)) GRID_BAR();
    }

    if (IN(3)) {
        pg8::Gemm g{A2, WoT, M, D, D}; pg8::StaticOrder S; S.init(M, D, F.G, (int)blockIdx.x);
        pg8::EpiResidual<true> E{x, out, X1B, ssq1, D};
        pg8::gemm_phase<pg8::EpiResidual<true>, pg8::StaticOrder, PG8_ALIGN, PG8_SP2, false>(F.lds + RING_OFF, g, S, E);
        if (BOTH(3)) GRID_BAR();
    }

    if (IN(4)) {
        pg8::Gemm g{X1B, WupT, M, FF, D}; pg8::StaticOrder S; S.init(M, FF, F.G, (int)blockIdx.x);
        pg8::EpiUp E{HB, FF, ssq1};
        pg8::gemm_phase<pg8::EpiUp, pg8::StaticOrder, PG8_ALIGN, PG8_SP2, false>(F.lds + RING_OFF, g, S, E);
        if (BOTH(4)) GRID_BAR();
    }

    if (IN(5)) {
        pg8::Gemm g{HB, WdnT, M, D, FF}; pg8::StaticOrder S; S.init(M, D, F.G, (int)blockIdx.x);
        pg8::EpiResidual<false> E{out, out, nullptr, ssq2, D};
        pg8::gemm_phase<pg8::EpiResidual<false>, pg8::StaticOrder, PG8_ALIGN, PG8_SP2, false>(F.lds + RING_OFF, g, S, E);
        if (BOTH(5)) GRID_BAR();
    }

    if (IN(6)) {
        f32x4 gv[4];
#pragma unroll
        for (int j = 0; j < 4; ++j) gv[j] = *((const GAS f32x4*)g3 + F.lane + 64 * j);
        for (int m = gw; m < M; m += NGW) {
            const GAS f32x4* sp = (const GAS f32x4*)(ssq2 + (size_t)m * 16);
            const f32x4 p0 = sp[0], p1 = sp[1], p2 = sp[2], p3 = sp[3];
            const float ss = ((p0[0] + p0[1]) + (p0[2] + p0[3])) + ((p1[0] + p1[1]) + (p1[2] + p1[3])) + ((p2[0] + p2[1]) + (p2[2] + p2[3])) + ((p3[0] + p3[1]) + (p3[2] + p3[3]));
            const float rs = 1.0f / sqrtf(ss * (1.0f / 1024.0f) + pg8::RMS_EPS);
            GAS f32x4* xr = (GAS f32x4*)(out + (size_t)m * D) + F.lane;
#pragma unroll
            for (int j = 0; j < 4; ++j) { const f32x4 v = xr[64 * j]; xr[64 * j] = v * rs * gv[j]; }
        }
    }
#undef IN
#undef BOTH
#undef GRID_BAR
}

extern "C" void kernel_launch(void* const* d_in, const int* in_sizes, int n_in, void* d_out, int out_size, void* d_ws, size_t ws_size, hipStream_t stream) {
    static int grid = 0;
    if (grid == 0) {
        if (n_in != 11 || in_sizes[0] != M * D || out_size != M * D || ws_size < WS_END) { fprintf(stderr, "kernel_launch: unexpected shapes (n_in %d, in0 %d, out %d, ws %zu); nothing launched\n", n_in, n_in > 0 ? in_sizes[0] : -1, out_size, ws_size); grid = -1; return; }
        int dev = 0, cus = 0, per_cu = 0;
        if (hipGetDevice(&dev) != hipSuccess || hipDeviceGetAttribute(&cus, hipDeviceAttributeMultiprocessorCount, dev) != hipSuccess) { fprintf(stderr, "kernel_launch: device query failed\n"); grid = -1; return; }
        if (hipFuncSetAttribute((const void*)hymba_fwd, hipFuncAttributeMaxDynamicSharedMemorySize, LDS_BYTES) != hipSuccess) { fprintf(stderr, "kernel_launch: hipFuncSetAttribute failed\n"); grid = -1; return; }
        if (hipOccupancyMaxActiveBlocksPerMultiprocessor(&per_cu, (const void*)hymba_fwd, NWAVES * 64, LDS_BYTES) != hipSuccess || per_cu < 1) { fprintf(stderr, "kernel_launch: occupancy query reports %d workgroups per CU\n", per_cu); per_cu = 1; }
        (void)hipGetLastError();
        grid = cus;
    }
    if (grid < 0) return;
    (void)hipMemsetAsync((char*)d_ws + WS_CTL, 0, CTL_ZERO_BYTES, stream);
    Args a{};
    for (int i = 0; i < 11; ++i) a.in[i] = (const float*)d_in[i];
    a.out = (float*)d_out; a.ws = (unsigned char*)d_ws;
    if (N_LAUNCHES == 1) {
        a.ph_lo = 0; a.ph_hi = PER_PHASE; a.li = 0;
        hipLaunchKernelGGL(hymba_fwd, dim3(grid), dim3(NWAVES * 64), LDS_BYTES, stream, a);
    } else {
        for (int li = 0; li < PER_PHASE; ++li) { a.ph_lo = li; a.ph_hi = li + 1; a.li = li;
            hipLaunchKernelGGL(hymba_fwd, dim3(grid), dim3(NWAVES * 64), LDS_BYTES, stream, a); }
    }
}
```
